# Optimizing an MI355X kernel written in HIP

```python
import math
import jax, jax.numpy as jnp
from jax import lax
import numpy as np

D_MODEL = 1024
BATCH = 8
SEQ = 4096
DEPTH = 1

CHUNK = 64
MEM_LEN = 256
CONV_WIDTH = D_MODEL // 2
CONV_KERNEL = 31
SSM_WIDTH = D_MODEL // 2
SSM_GROUP = 16
SSM_GROUPS = SSM_WIDTH // SSM_GROUP
SSM_STATE = 64
XATTN_HEADS = 4
XATTN_HEAD_DIM = 128
XATTN_WIDTH = XATTN_HEADS * XATTN_HEAD_DIM
N_BRANCH = 3
MOE_GROUPS = 4
EXPERTS_PER_GROUP = 8
N_EXPERTS = MOE_GROUPS * EXPERTS_PER_GROUP
TOP_K = 2
D_EXPERT = D_MODEL // 4
EPS = 1e-6
IN_COLS = 2 * CONV_WIDTH + SSM_WIDTH + XATTN_WIDTH + N_BRANCH * D_MODEL

kernel_name = "hybrid_conv_s5_memxattn_hmoe_block"


def rmsnorm(x, g):
    x32 = x.astype(jnp.float32)
    y = x32 * lax.rsqrt(jnp.mean(x32 * x32, axis=-1, keepdims=True) + EPS)
    return (y * g.astype(jnp.float32)).astype(x.dtype)


def layernorm(x, g, b):
    x32 = x.astype(jnp.float32)
    mu = jnp.mean(x32, axis=-1, keepdims=True)
    xc = x32 - mu
    var = jnp.mean(xc * xc, axis=-1, keepdims=True)
    y = xc * lax.rsqrt(var + EPS) * g.astype(jnp.float32) + b.astype(jnp.float32)
    return y.astype(x.dtype)


def conformer_conv(u2, w_dw, b_dw, ln_g, ln_b, w_pw):
    a, gate = jnp.split(u2, 2, axis=-1)
    v = a * jax.nn.sigmoid(gate)
    v = lax.conv_general_dilated(
        v, w_dw[:, None, :], window_strides=(1,),
        padding=[(CONV_KERNEL - 1, 0)],
        dimension_numbers=("NWC", "WIO", "NWC"),
        feature_group_count=CONV_WIDTH) + b_dw
    v = jax.nn.silu(layernorm(v, ln_g, ln_b))
    return v @ w_pw


def _ssm_combine(left, right):
    a_l, b_l = left
    a_r, b_r = right
    return a_l * a_r, a_r * b_l + b_r


def s5_ssm(u, lam_re, lam_im, log_dt, b_re, b_im, c_re, c_im, d, w_glu):
    bsz, seq, _ = u.shape
    ug = u.reshape(bsz, seq, SSM_GROUPS, SSM_GROUP).astype(jnp.float32)
    lam = lax.complex(lam_re.astype(jnp.float32), lam_im.astype(jnp.float32))
    dt = jnp.exp(log_dt.astype(jnp.float32))
    a_bar = jnp.exp(lam * dt[:, None])
    bmat = lax.complex(b_re.astype(jnp.float32), b_im.astype(jnp.float32))
    b_bar = ((a_bar - 1.0) / lam)[:, :, None] * bmat
    cmat = lax.complex(c_re.astype(jnp.float32), c_im.astype(jnp.float32))
    bu = jnp.einsum("bsgc,gpc->bsgp", ug, b_bar)
    a_elems = jnp.broadcast_to(a_bar[None, None], (1, seq, SSM_GROUPS, SSM_STATE))
    _, states = lax.associative_scan(_ssm_combine, (a_elems, bu), axis=1)
    y = jnp.real(jnp.einsum("bsgp,gcp->bsgc", states, cmat))
    y = y + d.astype(jnp.float32).reshape(SSM_GROUPS, SSM_GROUP) * ug
    y = y.reshape(bsz, seq, SSM_WIDTH).astype(u.dtype)
    za, zb = jnp.split(jax.nn.gelu(y) @ w_glu, 2, axis=-1)
    return za * jax.nn.sigmoid(zb)


def memory_cross_attention(q, mem_n, w_kv, w_o):
    bsz, seq, _ = q.shape
    qh = q.reshape(bsz, seq, XATTN_HEADS, XATTN_HEAD_DIM)
    k, v = jnp.split(mem_n @ w_kv, 2, axis=-1)
    kh = k.reshape(bsz, -1, XATTN_HEADS, XATTN_HEAD_DIM)
    vh = v.reshape(bsz, -1, XATTN_HEADS, XATTN_HEAD_DIM)
    s = jnp.einsum("bshd,bmhd->bhsm", qh, kh).astype(jnp.float32) * (XATTN_HEAD_DIM ** -0.5)
    p = jax.nn.softmax(s, axis=-1).astype(vh.dtype)
    o = jnp.einsum("bhsm,bmhd->bshd", p, vh).reshape(bsz, seq, XATTN_WIDTH)
    return o @ w_o


def hier_moe(h, w_rg, b_rg, w_re, b_re, w_gate, w_up, w_down):
    bsz, seq, dm = h.shape
    t = bsz * seq
    hf = h.reshape(t, dm)
    p_group = jax.nn.softmax((hf @ w_rg + b_rg).astype(jnp.float32), axis=-1)
    p_top, g_idx = lax.top_k(p_group, 1)
    logits_e = (hf @ w_re + b_re).astype(jnp.float32).reshape(t, MOE_GROUPS, EXPERTS_PER_GROUP)
    sel = jnp.take_along_axis(logits_e, g_idx[:, :, None], axis=1)[:, 0]
    p_in = jax.nn.softmax(sel, axis=-1)
    vals, e_idx = lax.top_k(p_in, TOP_K)
    weights = p_top * vals / jnp.sum(vals, axis=-1, keepdims=True)
    expert_id = (g_idx * EXPERTS_PER_GROUP + e_idx).reshape(-1)
    order = jnp.argsort(expert_id)
    tok = order // TOP_K
    xs = hf[tok]
    sizes = jnp.bincount(expert_id, length=N_EXPERTS).astype(jnp.int32)
    a = jax.nn.silu(lax.ragged_dot(xs, w_gate, sizes)) * lax.ragged_dot(xs, w_up, sizes)
    ys = lax.ragged_dot(a, w_down, sizes)
    ys = ys * weights.reshape(-1)[order][:, None].astype(ys.dtype)
    out = jax.ops.segment_sum(ys, tok, num_segments=t)
    return out.reshape(bsz, seq, dm)


def setup_inputs(seed: int = 0) -> dict:
    key = jax.random.key(seed)
    ks = jax.random.split(key, 32)
    f32 = jnp.float32
    nrm = lambda k, shape, s: jax.random.normal(k, shape, f32) * s
    L = DEPTH
    return {
        "x": nrm(ks[0], (BATCH, SEQ, D_MODEL), 1.0),
        "mem": nrm(ks[1], (BATCH, MEM_LEN, D_MODEL), 1.0),
        "g_mix": 1.0 + nrm(ks[2], (L, D_MODEL), 0.02),
        "w_in": nrm(ks[3], (L, D_MODEL, IN_COLS), D_MODEL ** -0.5),
        "conv_dw": nrm(ks[4], (L, CONV_KERNEL, CONV_WIDTH), CONV_KERNEL ** -0.5),
        "conv_dw_bias": nrm(ks[5], (L, CONV_WIDTH), 0.02),
        "conv_ln_g": 1.0 + nrm(ks[6], (L, CONV_WIDTH), 0.02),
        "conv_ln_b": nrm(ks[7], (L, CONV_WIDTH), 0.02),
        "w_conv_out": nrm(ks[8], (L, CONV_WIDTH, D_MODEL), CONV_WIDTH ** -0.5),
        "ssm_lambda_re": -0.5 + nrm(ks[9], (L, SSM_GROUPS, SSM_STATE), 0.01),
        "ssm_lambda_im": math.pi * jnp.arange(SSM_STATE, dtype=f32)[None, None, :]
                         + nrm(ks[10], (L, SSM_GROUPS, SSM_STATE), 0.01),
        "ssm_log_dt": jax.random.uniform(ks[11], (L, SSM_GROUPS), f32,
                                         math.log(1e-3), math.log(1e-1)),
        "ssm_b_re": nrm(ks[12], (L, SSM_GROUPS, SSM_STATE, SSM_GROUP), (2 * SSM_GROUP) ** -0.5),
        "ssm_b_im": nrm(ks[13], (L, SSM_GROUPS, SSM_STATE, SSM_GROUP), (2 * SSM_GROUP) ** -0.5),
        "ssm_c_re": nrm(ks[14], (L, SSM_GROUPS, SSM_GROUP, SSM_STATE), SSM_STATE ** -0.5),
        "ssm_c_im": nrm(ks[15], (L, SSM_GROUPS, SSM_GROUP, SSM_STATE), SSM_STATE ** -0.5),
        "ssm_d": nrm(ks[16], (L, SSM_WIDTH), 1.0),
        "w_ssm_glu": nrm(ks[17], (L, SSM_WIDTH, 2 * D_MODEL), SSM_WIDTH ** -0.5),
        "g_mem": 1.0 + nrm(ks[18], (L, D_MODEL), 0.02),
        "w_mem_kv": nrm(ks[19], (L, D_MODEL, 2 * XATTN_WIDTH), D_MODEL ** -0.5),
        "w_mem_out": nrm(ks[20], (L, XATTN_WIDTH, D_MODEL), XATTN_WIDTH ** -0.5),
        "w_out": nrm(ks[21], (L, D_MODEL, D_MODEL), D_MODEL ** -0.5),
        "g_ffn": 1.0 + nrm(ks[22], (L, D_MODEL), 0.02),
        "w_router_group": nrm(ks[23], (L, D_MODEL, MOE_GROUPS), D_MODEL ** -0.5),
        "b_router_group": nrm(ks[24], (L, MOE_GROUPS), 0.01),
        "w_router_expert": nrm(ks[25], (L, D_MODEL, N_EXPERTS), D_MODEL ** -0.5),
        "b_router_expert": nrm(ks[26], (L, N_EXPERTS), 0.01),
        "w_exp_gate": nrm(ks[27], (L, N_EXPERTS, D_MODEL, D_EXPERT), D_MODEL ** -0.5),
        "w_exp_up": nrm(ks[28], (L, N_EXPERTS, D_MODEL, D_EXPERT), D_MODEL ** -0.5),
        "w_exp_down": nrm(ks[29], (L, N_EXPERTS, D_EXPERT, D_MODEL), D_EXPERT ** -0.5),
        "g_final": 1.0 + nrm(ks[30], (D_MODEL,), 0.02),
    }


def reference(x, mem, g_mix, w_in, conv_dw, conv_dw_bias, conv_ln_g, conv_ln_b, w_conv_out,
              ssm_lambda_re, ssm_lambda_im, ssm_log_dt, ssm_b_re, ssm_b_im, ssm_c_re, ssm_c_im,
              ssm_d, w_ssm_glu, g_mem, w_mem_kv, w_mem_out, w_out, g_ffn,
              w_router_group, b_router_group, w_router_expert, b_router_expert,
              w_exp_gate, w_exp_up, w_exp_down, g_final):
    split_pts = [2 * CONV_WIDTH, 2 * CONV_WIDTH + SSM_WIDTH, 2 * CONV_WIDTH + SSM_WIDTH + XATTN_WIDTH]
    for l in range(DEPTH):
        h = rmsnorm(x, g_mix[l])
        proj = h @ w_in[l]
        conv_in, ssm_in, q, gates = jnp.split(proj, split_pts, axis=-1)
        y_conv = conformer_conv(conv_in, conv_dw[l], conv_dw_bias[l], conv_ln_g[l], conv_ln_b[l],
                                w_conv_out[l])
        y_ssm = s5_ssm(ssm_in, ssm_lambda_re[l], ssm_lambda_im[l], ssm_log_dt[l], ssm_b_re[l],
                       ssm_b_im[l], ssm_c_re[l], ssm_c_im[l], ssm_d[l], w_ssm_glu[l])
        mem_n = rmsnorm(mem, g_mem[l])
        y_mem = memory_cross_attention(q, mem_n, w_mem_kv[l], w_mem_out[l])
        g_a, g_b, g_c = jnp.split(jax.nn.sigmoid(gates), N_BRANCH, axis=-1)
        merged = g_a * y_conv + g_b * y_ssm + g_c * y_mem
        x = x + merged @ w_out[l]
        h2 = rmsnorm(x, g_ffn[l])
        x = x + hier_moe(h2, w_router_group[l], b_router_group[l], w_router_expert[l],
                         b_router_expert[l], w_exp_gate[l], w_exp_up[l], w_exp_down[l])
    return rmsnorm(x, g_final)
```

```cpp
#include <hip/hip_runtime.h>
#include <cstdio>
#include <cstdint>

#ifndef MK_N_LAUNCHES
#define MK_N_LAUNCHES 11
#endif
#ifndef DBG_CONV
#define DBG_CONV 1
#endif
#ifndef DBG_SSM
#define DBG_SSM 1
#endif
#ifndef DBG_MEM
#define DBG_MEM 1
#endif
#ifndef DBG_MOE
#define DBG_MOE 1
#endif

#define LAS __attribute__((address_space(3)))
typedef unsigned short bf16_t;
typedef short bf16x8 __attribute__((ext_vector_type(8)));
typedef float f32x4 __attribute__((ext_vector_type(4)));
typedef float f32x2 __attribute__((ext_vector_type(2)));
typedef float f32x16 __attribute__((ext_vector_type(16)));
typedef unsigned u32x4 __attribute__((ext_vector_type(4)));
typedef unsigned u32x2 __attribute__((ext_vector_type(2)));
typedef __bf16 bf16x2_t __attribute__((ext_vector_type(2)));

constexpr int BATCH = 8, SEQ = 4096, DM = 1024, NT = BATCH * SEQ, MEML = 256;
constexpr int CW = 512, CKW = 31, SW = 512, NG = 32, NP = 64, NH = 4, HD = 128, XW = 512;
constexpr int NE = 32, EPG = 8, MGR = 4, DE = 256;
constexpr int INC = 5120;
constexpr int LCH = 32, NCK = SEQ / LCH, KT = 128 + LCH * 16, NROW = BATCH * NCK;
constexpr float EPSN = 1e-6f;
constexpr int LCAP = 65536;
constexpr int MAXTILES = 288;

constexpr size_t MiB = 1u << 20;
constexpr size_t WS_CTL = 0, CTL_ZERO_BYTES = 1 * MiB;
constexpr size_t WS_RS1 = 1 * MiB, WS_RS2 = WS_RS1 + 131072, WS_WPAIR = WS_RS2 + 131072, WS_A32 = WS_WPAIR + 262144, WS_WRF = 2 * MiB;
constexpr size_t WS_MEMN = 3 * MiB;
constexpr size_t WS_W1T = 8 * MiB, WS_WKVT = 18 * MiB, WS_WCT = 20 * MiB, WS_WMOT = 21 * MiB, WS_WGLUT = 22 * MiB, WS_WOUTT = 24 * MiB;
constexpr size_t WS_TOEP = 26 * MiB;
constexpr size_t WS_EMAT = 46 * MiB;
constexpr size_t WS_A = 54 * MiB;
constexpr size_t WS_B = 118 * MiB;
constexpr size_t WS_YS = WS_B, WS_WGU = WS_B + 128 * MiB, WS_WDT = WS_WGU + 32 * MiB;
constexpr size_t WS_C1 = 310 * MiB;
constexpr size_t WS_C2 = 342 * MiB;
constexpr size_t WS_C3 = 374 * MiB;
constexpr size_t WS_MERGED = WS_C2;
constexpr size_t WS_C4 = 414 * MiB;
constexpr size_t WS_C5 = 446 * MiB;
constexpr size_t WS_ABUF = WS_C4;
constexpr size_t WS_C6 = 478 * MiB;
constexpr size_t WS_LIST = WS_C6;
constexpr size_t WS_C7 = 494 * MiB;
constexpr size_t WS_END = 510 * MiB;
constexpr int CW_BAR = 4096;
constexpr int CW_CNT = 1024;

constexpr int RING_BYTES = 139264;
constexpr int LDSCTL_OFF = RING_BYTES;
constexpr int LDS_BYTES = 147456;

__device__ __forceinline__ unsigned f2bf(float f) { unsigned u = __builtin_bit_cast(unsigned, f); return (u + 0x7fffu + ((u >> 16) & 1u)) >> 16; }
__device__ __forceinline__ unsigned pk2(float lo, float hi) { f32x2 v = {lo, hi}; bf16x2_t b = __builtin_convertvector(v, bf16x2_t); return __builtin_bit_cast(unsigned, b); }
__device__ __forceinline__ float bflo(unsigned w) { return __builtin_bit_cast(float, w << 16); }
__device__ __forceinline__ float bfhi(unsigned w) { return __builtin_bit_cast(float, w & 0xffff0000u); }
__device__ __forceinline__ float sigmoidf_(float x) { return __builtin_amdgcn_rcpf(1.0f + __builtin_amdgcn_exp2f(-1.4426950408889634f * x)); }
__device__ __forceinline__ float geluf_(float x) { const float u = 1.5957691216057308f * (x + 0.044715f * x * x * x); return x * sigmoidf_(u); }
__device__ __forceinline__ float wave_sum(float v) {
#pragma unroll
    for (int o = 1; o < 64; o <<= 1) v += __shfl_xor(v, o);
    return v;
}
#define LDS_WAIT() asm volatile("s_waitcnt lgkmcnt(0)" ::: "memory")
#define VM_WAIT() asm volatile("s_waitcnt vmcnt(0)" ::: "memory")

namespace pg8 {
constexpr int BM = 256, BK = 64, HALF = 128, HTB = HALF * BK * 2, STAGE_BYTES = 8 * HTB, NXCD = 8, WGM = 8;
__host__ __device__ __forceinline__ int lds_byte(int r, int c) { const int st = (r >> 4) * 2 + (c >> 5), rr = r & 15, cc = c & 31, ob = rr * 64 + cc * 2; return st * 1024 + (ob ^ (((ob >> 9) & 1) << 5)); }
__host__ __device__ __forceinline__ void stage_rc(int b, int& R, int& C) { const int st = b / 1024, sb = b % 1024, swz = sb ^ (((sb >> 9) & 1) << 5); R = (st >> 1) * 16 + swz / 64; C = (st & 1) * 32 + (swz % 64) / 2; }
__host__ __device__ __forceinline__ int perm32(int rho) { const int n = rho >> 4, i = rho & 15; return 8 * (i >> 2) + 4 * n + (i & 3); }

struct Unit { const char* A; const char* B; char* O; const int* gl; int pm, pn, aux, flags, gvalid; };

struct TileOrder {
    int nM, nN, nwg;
    __device__ __forceinline__ void init(int nM_, int nN_) { nM = nM_; nN = nN_; nwg = nM * nN; }
    __device__ __forceinline__ void map(int L, int& pm, int& pn) const {
        int wgid = L; { const int q = nwg / NXCD, r = nwg % NXCD, xcd = wgid % NXCD, off = wgid / NXCD; wgid = (xcd < r ? xcd * (q + 1) : r * (q + 1) + (xcd - r) * q) + off; }
        const int nig = WGM * nN, gid = wgid / nig, fm = gid * WGM, gsz = (nM - fm) < WGM ? (nM - fm) : WGM;
        pm = fm + ((wgid % nig) % gsz); pn = (wgid % nig) / gsz;
    }
};

template <class Epi, class Sched, bool GATHER>
__device__ __forceinline__ void gemm_phase(LAS unsigned char* lds, const int lda, const int ldb, const int K, const Sched& S, const Epi& E) {
    const int tid = threadIdx.x, wid = __builtin_amdgcn_readfirstlane(tid >> 6), lane = tid & 63, wr = wid >> 2, wc = wid & 3, fr = lane & 15, fq = lane >> 4;
    const int nt = K / BK;
    unsigned voffA[2], voffB[2]; int gR[2], gC[2];
#pragma unroll
    for (int i = 0; i < 2; ++i) { int R, C; stage_rc(tid * 16 + i * 8192, R, C); const int Rb = (R & ~31) + perm32(R & 31);
        voffA[i] = (unsigned)(R * lda + C) * 2u; voffB[i] = (unsigned)(Rb * ldb + C) * 2u; gR[i] = R; gC[i] = C; }
    const size_t kstep = (size_t)(BK * 2);
    const size_t hstepA = (size_t)HALF * lda * 2, hstepB = (size_t)HALF * ldb * 2;
    const unsigned ldsw = (unsigned)wid * 1024u;
    const int aoff = lds_byte(wr * 64 + fr, fq * 8), boff = lds_byte(wc * 32 + fr, fq * 8);
#define PG8_SA(b, h) (((b) * 2 + (h)) * HTB)
#define PG8_SB(b, h) ((4 + (b) * 2 + (h)) * HTB)
#define PG8_GLDS(gptr, ldsoff) __builtin_amdgcn_global_load_lds((const unsigned*)(gptr), (LAS unsigned*)(lds + (ldsoff)), 16, 0, 0)
#define PG8_STAGE_B(bufoff, gbase) do { PG8_GLDS((gbase) + voffB[0], (bufoff) + ldsw); PG8_GLDS((gbase) + voffB[1], (bufoff) + ldsw + 8192); } while (0)
#define PG8_STAGE_A(bufoff, nextsel, h, kb) do { \
        if constexpr (GATHER) { const unsigned o0_ = (nextsel) ? noff[h][0] : coff[h][0], o1_ = (nextsel) ? noff[h][1] : coff[h][1]; const char* p_ = gA + (kb); \
            PG8_GLDS(p_ + o0_, (bufoff) + ldsw); PG8_GLDS(p_ + o1_, (bufoff) + ldsw + 8192); } \
        else { const char* p_ = ((nextsel) ? nA : cA) + (size_t)(h) * hstepA + (kb); PG8_GLDS(p_ + voffA[0], (bufoff) + ldsw); PG8_GLDS(p_ + voffA[1], (bufoff) + ldsw + 8192); } } while (0)
#define PG8_LDA(dst, b, h) do { _Pragma("unroll") for (int m = 0; m < 4; ++m) _Pragma("unroll") for (int k = 0; k < 2; ++k) dst[m][k] = *(const LAS bf16x8*)(lds + PG8_SA(b, h) + aoff + m * 2048 + k * 1024); } while (0)
#define PG8_LDB(dst, b, h) do { _Pragma("unroll") for (int n = 0; n < 2; ++n) _Pragma("unroll") for (int k = 0; k < 2; ++k) dst[n][k] = *(const LAS bf16x8*)(lds + PG8_SB(b, h) + boff + n * 2048 + k * 1024); } while (0)
#define PG8_MMA(ai, bj, At, Bt) do { __builtin_amdgcn_s_setprio(1); _Pragma("unroll") for (int m = 0; m < 4; ++m) _Pragma("unroll") for (int n = 0; n < 2; ++n) _Pragma("unroll") for (int k = 0; k < 2; ++k) \
        acc[ai][bj][m][n] = __builtin_amdgcn_mfma_f32_16x16x32_bf16(Bt[n][k], At[m][k], acc[ai][bj][m][n], 0, 0, 0); __builtin_amdgcn_s_setprio(0); } while (0)
#define PG8_WAIT_V(n) asm volatile("s_waitcnt vmcnt(" #n ")" ::: "memory")
#define PG8_WAIT_L(n) asm volatile("s_waitcnt lgkmcnt(" #n ")" ::: "memory")
#define PG8_BAR __builtin_amdgcn_s_barrier()
#define PG8_SCHED __builtin_amdgcn_sched_barrier(0)
    Unit cur, nxt; int ui = 0;
    if (!S.next(0, cur)) return;
    unsigned coff[2][2] = {{0u, 0u}, {0u, 0u}}, noff[2][2] = {{0u, 0u}, {0u, 0u}};
    const char* gA = GATHER ? cur.A : nullptr;
    if constexpr (GATHER) {
#pragma unroll
        for (int h = 0; h < 2; ++h)
#pragma unroll
            for (int i = 0; i < 2; ++i) { const int r = h * HALF + gR[i]; const int idx = cur.gl[r < cur.gvalid ? r : 0] >> 1; coff[h][i] = (unsigned)idx * (unsigned)(lda * 2) + (unsigned)(gC[i] * 2); }
        VM_WAIT();
    }
    f32x4 acc[2][2][4][2];
#pragma unroll
    for (int a = 0; a < 2; ++a)
#pragma unroll
        for (int b = 0; b < 2; ++b)
#pragma unroll
            for (int m = 0; m < 4; ++m)
#pragma unroll
                for (int n = 0; n < 2; ++n) acc[a][b][m][n] = (f32x4){0.f, 0.f, 0.f, 0.f};
    bf16x8 At[4][2], B0[2][2], B1[2][2];
    const char* cA = cur.A; const char* cB = cur.B; const char* nA = cA; const char* nB = cB;
    PG8_STAGE_B(PG8_SB(0, 0), cB); PG8_STAGE_B(PG8_SB(0, 1), cB + hstepB); PG8_STAGE_A(PG8_SA(0, 0), false, 0, (size_t)0); PG8_STAGE_A(PG8_SA(0, 1), false, 1, (size_t)0);
    if (wr == 1) PG8_BAR;
    PG8_WAIT_V(2); PG8_BAR;
    PG8_STAGE_B(PG8_SB(1, 0), cB + kstep); PG8_STAGE_A(PG8_SA(1, 0), false, 0, kstep); PG8_STAGE_B(PG8_SB(1, 1), cB + hstepB + kstep);
    PG8_WAIT_V(6); PG8_BAR;
    for (;;) {
        const bool has_next = S.next(ui + 1, nxt);
        nA = has_next ? nxt.A : cA; nB = has_next ? nxt.B : cB;
        if constexpr (GATHER) {
            if (has_next) {
#pragma unroll
                for (int h = 0; h < 2; ++h)
#pragma unroll
                    for (int i = 0; i < 2; ++i) { const int r = h * HALF + gR[i]; const int idx = nxt.gl[r < nxt.gvalid ? r : 0] >> 1; noff[h][i] = (unsigned)idx * (unsigned)(lda * 2) + (unsigned)(gC[i] * 2); }
                VM_WAIT();
            } else {
#pragma unroll
                for (int h = 0; h < 2; ++h)
#pragma unroll
                    for (int i = 0; i < 2; ++i) noff[h][i] = coff[h][i];
            }
        }
#pragma unroll 1
        for (int t = 0; t < nt; t += 2) {
            const bool last = (t == nt - 2);
            const size_t kb1 = (size_t)(t + 1) * kstep;
            const size_t kb2 = last ? (size_t)0 : (size_t)(t + 2) * kstep; const size_t kb3 = kb2 + kstep;
            const char* b2 = (last ? nB : cB) + kb2; const char* b3 = b2 + kstep;
            PG8_LDB(B0, 0, 0); PG8_LDB(B1, 0, 1); PG8_SCHED; PG8_LDA(At, 0, 0); PG8_STAGE_A(PG8_SA(1, 1), false, 1, kb1);
            PG8_WAIT_V(8); PG8_WAIT_L(0); PG8_BAR; PG8_MMA(0, 0, At, B0); PG8_MMA(0, 1, At, B1); PG8_BAR; PG8_SCHED;
            PG8_LDA(At, 0, 1); PG8_STAGE_B(PG8_SB(0, 0), b2); PG8_STAGE_B(PG8_SB(0, 1), b2 + hstepB); PG8_STAGE_A(PG8_SA(0, 0), last, 0, kb2);
            PG8_WAIT_V(8); PG8_WAIT_L(0); PG8_BAR; PG8_MMA(1, 0, At, B0); PG8_MMA(1, 1, At, B1); PG8_BAR; PG8_SCHED;
            PG8_LDB(B0, 1, 0); PG8_LDB(B1, 1, 1); PG8_SCHED; PG8_LDA(At, 1, 0); PG8_STAGE_A(PG8_SA(0, 1), last, 1, kb2);
            PG8_WAIT_V(8); PG8_WAIT_L(0); PG8_BAR; PG8_MMA(0, 0, At, B0); PG8_MMA(0, 1, At, B1); PG8_BAR; PG8_SCHED;
            PG8_LDA(At, 1, 1); PG8_STAGE_B(PG8_SB(1, 0), b3); PG8_STAGE_B(PG8_SB(1, 1), b3 + hstepB); PG8_STAGE_A(PG8_SA(1, 0), last, 0, kb3);
            PG8_WAIT_V(8); PG8_WAIT_L(0); PG8_BAR; PG8_MMA(1, 0, At, B0); PG8_MMA(1, 1, At, B1); PG8_BAR; PG8_SCHED;
        }
        if (wr == 0) PG8_BAR;
        E(acc, cur, wr, wc, fr, fq);
        if (!has_next) break;
        if (!(cur.flags & 1)) {
#pragma unroll
            for (int a = 0; a < 2; ++a)
#pragma unroll
                for (int b = 0; b < 2; ++b)
#pragma unroll
                    for (int m = 0; m < 4; ++m)
#pragma unroll
                        for (int n = 0; n < 2; ++n) acc[a][b][m][n] = (f32x4){0.f, 0.f, 0.f, 0.f};
        }
        cur = nxt; cA = nA; cB = nB; ++ui;
        if constexpr (GATHER) {
#pragma unroll
            for (int h = 0; h < 2; ++h)
#pragma unroll
                for (int i = 0; i < 2; ++i) coff[h][i] = noff[h][i];
        }
        if (wr == 1) PG8_BAR;
    }
    PG8_WAIT_V(0);
    PG8_BAR;
#undef PG8_SA
#undef PG8_SB
#undef PG8_GLDS
#undef PG8_STAGE_A
#undef PG8_STAGE_B
#undef PG8_LDA
#undef PG8_LDB
#undef PG8_MMA
#undef PG8_WAIT_V
#undef PG8_WAIT_L
#undef PG8_BAR
#undef PG8_SCHED
}
}
using pg8::Unit;

#define XB_TMO      128
#define XB_XCNT(j)  (256  + 64 * (j))
#define XB_XSUB(j)  (1280 + 64 * (j))
#define XB_XGEN(j)  (2304 + 64 * (j))
#define XB_TOP      3328
#define XB_TOPGEN   3392
#define XCD_BAR_WORDS 3456
#define XB_SPIN_CAP (1u << 18)
__device__ __forceinline__ unsigned xb_ld(unsigned* p)              { return __hip_atomic_load(p, __ATOMIC_RELAXED, __HIP_MEMORY_SCOPE_AGENT); }
__device__ __forceinline__ unsigned xb_add(unsigned* p, unsigned v) { return __hip_atomic_fetch_add(p, v, __ATOMIC_RELAXED, __HIP_MEMORY_SCOPE_AGENT); }
__device__ __forceinline__ unsigned xb_xcc_id() { return (unsigned)__builtin_amdgcn_s_getreg((3 << 11) | 20) & 0xFu; }
#define XB_SPIN(cond, bar) do { unsigned _sp = 0; while (cond) { __builtin_amdgcn_s_sleep(1); \
    if ((++_sp & 255u) == 0u) { if (xb_ld(&(bar)[XB_TMO])) break; if (_sp > XB_SPIN_CAP) { atomicAdd(&(bar)[XB_TMO], 1u); break; } } } } while (0)
struct XcdBarrier { unsigned* bar; unsigned x; volatile LAS unsigned* st; };
__device__ __forceinline__ XcdBarrier xcd_barrier_post(unsigned* bar, volatile LAS unsigned* st) {
    XcdBarrier b; b.bar = bar; b.x = xb_xcc_id(); b.st = st;
    if (threadIdx.x == 0) (void)xb_add(&bar[XB_XCNT(b.x)], 1u);
    return b;
}
__device__ __forceinline__ void xcd_barrier_complete(unsigned* bar, unsigned x, unsigned& nloc, unsigned& nx) {
    const unsigned G = gridDim.x * gridDim.y * gridDim.z;
    unsigned sum, cnt, mine, sp = 0u;
    for (;;) {
        sum = 0u; cnt = 0u; mine = 0u;
#pragma unroll
        for (unsigned j = 0; j < 16; ++j) { const unsigned c = xb_ld(&bar[XB_XCNT(j)]); sum += c; cnt += (c > 0u) ? 1u : 0u; mine = (j == x) ? c : mine; }
        if (sum == G) break;
        __builtin_amdgcn_s_sleep(1);
        if ((++sp & 255u) == 0u) { if (xb_ld(&bar[XB_TMO])) break; if (sp > XB_SPIN_CAP) { atomicAdd(&bar[XB_TMO], 1u); break; } }
    }
    nloc = mine > 0u ? mine : 1u; nx = cnt > 0u ? cnt : 1u;
}
__device__ __forceinline__ void xcd_barrier(const XcdBarrier& b) {
    asm volatile("s_waitcnt vmcnt(0)" ::: "memory");
    __syncthreads();
    if (threadIdx.x == 0) {
        unsigned* bar = b.bar;
        __builtin_amdgcn_s_waitcnt(0);
        unsigned nloc = b.st[0], nx = b.st[1];
        if (nloc == 0u) { xcd_barrier_complete(bar, b.x, nloc, nx); b.st[0] = nloc; b.st[1] = nx; }
        const unsigned old = xb_add(&bar[XB_XSUB(b.x)], 1u);
        const unsigned gen = old / nloc;
        if (old + 1u == (gen + 1u) * nloc) {
            __builtin_amdgcn_fence(__ATOMIC_RELEASE, "agent");
            asm volatile("s_waitcnt vmcnt(0)" ::: "memory");
            const unsigned og = xb_add(&bar[XB_TOP], 1u);
            const unsigned tg = og / nx;
            if (og + 1u == (tg + 1u) * nx) xb_add(&bar[XB_TOPGEN], 1u);
            else XB_SPIN(xb_ld(&bar[XB_TOPGEN]) == tg, bar);
            __builtin_amdgcn_fence(__ATOMIC_ACQUIRE, "agent");
            xb_add(&bar[XB_XGEN(b.x)], 1u);
            asm volatile("s_waitcnt vmcnt(0)" ::: "memory");
        } else {
            XB_SPIN(xb_ld(&bar[XB_XGEN(b.x)]) == gen, bar);
            __builtin_amdgcn_fence(__ATOMIC_ACQUIRE, "agent");
            asm volatile("s_waitcnt vmcnt(0)" ::: "memory");
        }
    }
    __syncthreads();
}

struct Args { const float* in[31]; float* out; unsigned char* ws; int ph_lo, ph_hi, li, pad; };
enum InIdx { I_X = 0, I_MEM, I_GMIX, I_WIN, I_CONVDW, I_CONVB, I_LNG, I_LNB, I_WCONVOUT, I_LAMRE, I_LAMIM, I_LOGDT, I_BRE, I_BIM, I_CRE, I_CIM, I_SSMD, I_WGLU, I_GMEM, I_WKV, I_WMO, I_WOUT,
             I_GFFN, I_WRG, I_BRG, I_WRE, I_BRE_E, I_WEG, I_WEU, I_WED, I_GFINAL };

__device__ __forceinline__ void tr_item(const float* W, int ldw, int c0, const float* rs, float cs, bf16_t* dst, int ldd, int n0, int k0, LAS float* scr, int lane) {
#pragma unroll 8
    for (int i = 0; i < 32; ++i) { const int kk = 2 * i + (lane >> 5); float w = W[(size_t)(k0 + kk) * ldw + c0 + (lane & 31)]; if (rs) w *= rs[k0 + kk]; scr[kk * 33 + (lane & 31)] = w * cs; }
    LDS_WAIT(); asm volatile("" ::: "memory");
    const int c = lane & 7;
#pragma unroll
    for (int j = 0; j < 4; ++j) { const int n = (lane >> 3) + 8 * j; const LAS float* s = scr + (8 * c) * 33 + n;
        u32x4 o; o.x = pk2(s[0 * 33], s[1 * 33]); o.y = pk2(s[2 * 33], s[3 * 33]); o.z = pk2(s[4 * 33], s[5 * 33]); o.w = pk2(s[6 * 33], s[7 * 33]);
        *(u32x4*)(dst + (size_t)(n0 + n) * ldd + k0 + 8 * c) = o; }
    LDS_WAIT(); asm volatile("" ::: "memory");
}
__device__ __forceinline__ int w1_colmap(int n) {
    if (n < 1024) { const int pn = n >> 8, j = n & 255; return j < 128 ? 128 * pn + j : 512 + 128 * pn + (j - 128); }
    return n;
}
__device__ __forceinline__ float row_to_bf16(const float* xrow, bf16_t* orow, int lane, bool scaled) {
    const f32x4* xr = (const f32x4*)xrow + lane;
    f32x4 v[4]; float s = 0.f;
#pragma unroll
    for (int j = 0; j < 4; ++j) { v[j] = xr[64 * j]; s += (v[j].x * v[j].x + v[j].y * v[j].y) + (v[j].z * v[j].z + v[j].w * v[j].w); }
    const float rs = 1.0f / sqrtf(wave_sum(s) * (1.f / DM) + EPSN);
    const float m = scaled ? rs : 1.f;
    u32x2* o8 = (u32x2*)orow + lane;
#pragma unroll
    for (int j = 0; j < 4; ++j) { u32x2 w; w.x = pk2(v[j].x * m, v[j].y * m); w.y = pk2(v[j].z * m, v[j].w * m); o8[64 * j] = w; }
    return rs;
}
__device__ __forceinline__ void cpow_(float lr, float li, float dt, int n, float& re, float& im) {
    const float mag = expf((float)n * lr * dt);
    double rev = (double)n * (double)li * (double)dt * 0.15915494309189535; rev -= rint(rev);
    const float fr = (float)rev;
    re = mag * __builtin_amdgcn_cosf(fr); im = mag * __builtin_amdgcn_sinf(fr);
}

#define EPI_ARGS const f32x4 (&acc)[2][2][4][2], const Unit& u, int wr, int wc, int fr, int fq
__device__ __forceinline__ u32x4 pack8(const f32x4& a, const f32x4& b) { u32x4 w; w.x = pk2(a[0], a[1]); w.y = pk2(a[2], a[3]); w.z = pk2(b[0], b[1]); w.w = pk2(b[2], b[3]); return w; }
__device__ __forceinline__ void unpack8(const u32x4& w, f32x4& a, f32x4& b) { a = (f32x4){bflo(w.x), bfhi(w.x), bflo(w.y), bfhi(w.y)}; b = (f32x4){bflo(w.z), bfhi(w.z), bflo(w.w), bfhi(w.w)}; }
__device__ __forceinline__ f32x4 sig4(const f32x4& a) { return (f32x4){sigmoidf_(a[0]), sigmoidf_(a[1]), sigmoidf_(a[2]), sigmoidf_(a[3])}; }

struct EpiP1 {
    const float* rs1; bf16_t* v; bf16_t* ug; bf16_t* q; bf16_t* gates;
    __device__ __forceinline__ void operator()(EPI_ARGS) const {
        const int pn = u.pn, row0 = u.pm * 256 + wr * 64 + fr, cl = wc * 32 + 8 * fq;
#pragma unroll
        for (int ai = 0; ai < 2; ++ai)
#pragma unroll
            for (int m = 0; m < 4; ++m) {
                const int row = row0 + ai * 128 + m * 16; const float rs = rs1[row];
                if (pn < 4) {
                    const f32x4 a0 = acc[ai][0][m][0] * rs, a1 = acc[ai][0][m][1] * rs, g0 = sig4(acc[ai][1][m][0] * rs), g1 = sig4(acc[ai][1][m][1] * rs);
                    *(u32x4*)(v + (size_t)row * CW + 128 * pn + cl) = pack8(a0 * g0, a1 * g1);
                } else if (pn < 6) {
#pragma unroll
                    for (int bj = 0; bj < 2; ++bj) { const int cc = 256 * (pn - 4) + 128 * bj + cl, g = cc >> 4, c0 = cc & 15;
                        *(u32x4*)(ug + ((size_t)(g * NROW + (row >> 5)) * KT + 128 + (row & 31) * 16 + c0)) = pack8(acc[ai][bj][m][0] * rs, acc[ai][bj][m][1] * rs); }
                } else if (pn < 8) {
#pragma unroll
                    for (int bj = 0; bj < 2; ++bj) *(u32x4*)(q + (size_t)row * XW + 256 * (pn - 6) + 128 * bj + cl) = pack8(acc[ai][bj][m][0] * rs, acc[ai][bj][m][1] * rs);
                } else {
                    const int gi = (pn - 8) >> 2; bf16_t* gb = gates + (size_t)gi * NT * DM + (size_t)row * DM + 256 * ((pn - 8) & 3) + cl;
#pragma unroll
                    for (int bj = 0; bj < 2; ++bj) *(u32x4*)(gb + 128 * bj) = pack8(sig4(acc[ai][bj][m][0] * rs), sig4(acc[ai][bj][m][1] * rs));
                }
            }
    }
};
struct EpiF32 {
    int ldc, ncols;
    __device__ __forceinline__ void operator()(EPI_ARGS) const {
        float* O = (float*)u.O; const int row0 = u.pm * 256 + wr * 64 + fr;
#pragma unroll
        for (int bj = 0; bj < 2; ++bj) { const int col = u.pn * 256 + 128 * bj + wc * 32 + 8 * fq; if (col < ncols) {
#pragma unroll
            for (int ai = 0; ai < 2; ++ai)
#pragma unroll
                for (int m = 0; m < 4; ++m) { float* p = O + (size_t)(row0 + ai * 128 + m * 16) * ldc + col; *(f32x4*)p = acc[ai][bj][m][0]; *(f32x4*)(p + 4) = acc[ai][bj][m][1]; } } }
    }
};
struct EpiP4 {
    const bf16_t* ug; const float* dvec; bf16_t* yg;
    __device__ __forceinline__ void operator()(EPI_ARGS) const {
        const int g = u.aux, row0 = u.pm * 256 + wr * 64 + fr;
#pragma unroll
        for (int bj = 0; bj < 2; ++bj) {
            const int col = u.pn * 256 + 128 * bj + wc * 32 + 8 * fq, tau = col >> 4, c0 = col & 15;
            const f32x4 d0 = *(const f32x4*)(dvec + g * 16 + c0), d1 = *(const f32x4*)(dvec + g * 16 + c0 + 4);
#pragma unroll
            for (int ai = 0; ai < 2; ++ai)
#pragma unroll
                for (int m = 0; m < 4; ++m) { const int R = row0 + ai * 128 + m * 16;
                    const u32x4 uw = *(const u32x4*)(ug + ((size_t)(g * NROW + R) * KT + 128 + col)); f32x4 u0, u1; unpack8(uw, u0, u1);
                    f32x4 y0 = acc[ai][bj][m][0] + d0 * u0, y1 = acc[ai][bj][m][1] + d1 * u1;
                    y0 = (f32x4){geluf_(y0[0]), geluf_(y0[1]), geluf_(y0[2]), geluf_(y0[3])}; y1 = (f32x4){geluf_(y1[0]), geluf_(y1[1]), geluf_(y1[2]), geluf_(y1[3])};
                    *(u32x4*)(yg + (size_t)(R * 32 + tau) * SW + g * 16 + c0) = pack8(y0, y1); }
        }
    }
};
struct EpiP5 {
    const bf16_t* gates; bf16_t* coef; bf16_t* merged;
    __device__ __forceinline__ void operator()(EPI_ARGS) const {
        f32x4 (&a)[2][2][4][2] = const_cast<f32x4 (&)[2][2][4][2]>(acc);
        const int s = u.aux, row0 = u.pm * 256 + wr * 64 + fr, col0 = u.pn * 256 + wc * 32 + 8 * fq;
        const bf16_t* ga = gates; const bf16_t* gb = gates + (size_t)NT * DM; const bf16_t* gc = gates + (size_t)2 * NT * DM;
        if (s == 2) VM_WAIT();
#pragma unroll
        for (int ai = 0; ai < 2; ++ai)
#pragma unroll
            for (int m = 0; m < 4; ++m)
#pragma unroll
                for (int bj = 0; bj < 2; ++bj) {
                    const size_t off = (size_t)(row0 + ai * 128 + m * 16) * DM + col0 + 128 * bj;
                    f32x4 x0, x1, y0, y1;
                    if (s == 0) { unpack8(*(const u32x4*)(gb + off), x0, x1); *(u32x4*)(coef + off) = pack8(x0 * sig4(a[ai][bj][m][0]), x1 * sig4(a[ai][bj][m][1])); }
                    else if (s == 1) { unpack8(*(const u32x4*)(ga + off), x0, x1); unpack8(*(const u32x4*)(gc + off), y0, y1);
#pragma unroll
                        for (int e = 0; e < 4; ++e) { a[ai][bj][m][0][e] *= x0[e] * __builtin_amdgcn_rcpf(fmaxf(y0[e], 1e-30f)); a[ai][bj][m][1][e] *= x1[e] * __builtin_amdgcn_rcpf(fmaxf(y1[e], 1e-30f)); } }
                    else if (s == 2) { unpack8(*(const u32x4*)(gc + off), x0, x1); unpack8(*(const u32x4*)(coef + off), y0, y1);
#pragma unroll
                        for (int e = 0; e < 4; ++e) { a[ai][bj][m][0][e] *= x0[e] * __builtin_amdgcn_rcpf(fmaxf(y0[e], 1e-30f)); a[ai][bj][m][1][e] *= x1[e] * __builtin_amdgcn_rcpf(fmaxf(y1[e], 1e-30f)); } }
                    else { unpack8(*(const u32x4*)(coef + off), x0, x1); *(u32x4*)(merged + off) = pack8(a[ai][bj][m][0] * x0, a[ai][bj][m][1] * x1); }
                }
    }
};
struct EpiP6 {
    const float* x; float* x1; bf16_t* x1b;
    __device__ __forceinline__ void operator()(EPI_ARGS) const {
        const int row0 = u.pm * 256 + wr * 64 + fr, col0 = u.pn * 256 + wc * 32 + 8 * fq;
#pragma unroll
        for (int ai = 0; ai < 2; ++ai)
#pragma unroll
            for (int m = 0; m < 4; ++m)
#pragma unroll
                for (int bj = 0; bj < 2; ++bj) { const size_t off = (size_t)(row0 + ai * 128 + m * 16) * DM + col0 + 128 * bj;
                    const f32x4 r0 = *(const f32x4*)(x + off) + acc[ai][bj][m][0], r1 = *(const f32x4*)(x + off + 4) + acc[ai][bj][m][1];
                    *(f32x4*)(x1 + off) = r0; *(f32x4*)(x1 + off + 4) = r1; *(u32x4*)(x1b + off) = pack8(r0, r1); }
    }
};
struct EpiP8 {
    const float* rs2; bf16_t* abuf;
    __device__ __forceinline__ void operator()(EPI_ARGS) const {
        const int rl0 = wr * 64 + fr, cl = wc * 32 + 8 * fq;
#pragma unroll
        for (int ai = 0; ai < 2; ++ai)
#pragma unroll
            for (int m = 0; m < 4; ++m) { const int r = rl0 + ai * 128 + m * 16; const int pair = u.gl[r < u.gvalid ? r : 0]; const float rs = rs2[pair >> 1];
                f32x4 g0 = acc[ai][0][m][0] * rs, g1 = acc[ai][0][m][1] * rs; const f32x4 u0 = acc[ai][1][m][0] * rs, u1 = acc[ai][1][m][1] * rs;
                g0 = g0 * sig4(g0) * u0; g1 = g1 * sig4(g1) * u1;
                *(u32x4*)(abuf + (size_t)(u.aux + r) * DE + 128 * u.pn + cl) = pack8(g0, g1); }
    }
};
struct EpiP9 {
    const float* wpair; bf16_t* ys; bf16_t* dump;
    __device__ __forceinline__ void operator()(EPI_ARGS) const {
        const int rl0 = wr * 64 + fr, col0 = u.pn * 256 + wc * 32 + 8 * fq;
#pragma unroll
        for (int ai = 0; ai < 2; ++ai)
#pragma unroll
            for (int m = 0; m < 4; ++m) { const int r = rl0 + ai * 128 + m * 16; const bool ok = r < u.gvalid;
                const int pair = u.gl[ok ? r : 0]; const float w = wpair[pair];
                bf16_t* dst = (ok ? ys + (size_t)pair * DM : dump) + col0;
#pragma unroll
                for (int bj = 0; bj < 2; ++bj) *(u32x4*)(dst + 128 * bj) = pack8(acc[ai][bj][m][0] * w, acc[ai][bj][m][1] * w); }
    }
};

struct SchedGrid {
    pg8::TileOrder ord; int G, c; const char* A; const char* B; size_t tA, tB;
    __device__ __forceinline__ bool next(int i, Unit& u) const {
        const long L = (long)i * G + c; if (L >= ord.nwg) return false;
        ord.map((int)L, u.pm, u.pn); u.A = A + (size_t)u.pm * tA; u.B = B + (size_t)u.pn * tB; u.O = nullptr; u.gl = nullptr; u.aux = 0; u.flags = 0; u.gvalid = 0; return true;
    }
};
struct SchedOne {
    Unit u0; bool have;
    __device__ __forceinline__ bool next(int i, Unit& u) const { if (i != 0 || !have) return false; u = u0; return true; }
};
struct SchedP5 {
    pg8::TileOrder ord; int G, c; const char* ws;
    __device__ __forceinline__ bool next(int i, Unit& u) const {
        const int ti = i >> 2, s = i & 3; const long L = (long)ti * G + c; if (L >= ord.nwg) return false;
        ord.map((int)L, u.pm, u.pn);
        const size_t ra = (size_t)u.pm * 256 * 512 * 2, rb = (size_t)u.pn * 256 * 512 * 2;
        const size_t oa = (s == 1) ? WS_C4 : (s == 2) ? WS_C5 : WS_C1;
        const size_t ob = (s == 0) ? WS_WGLUT + (size_t)1024 * 512 * 2 : (s == 1) ? WS_WCT : (s == 2) ? WS_WMOT : WS_WGLUT;
        u.A = ws + oa + ra; u.B = ws + ob + rb;
        u.O = nullptr; u.gl = nullptr; u.aux = s; u.flags = (s == 1 || s == 2) ? 1 : 0; u.gvalid = 0; return true;
    }
};
struct SchedMoe {
    const volatile LAS int* tab; int G, c, npn_shift; const char* A; const char* B; size_t eB, tB; const int* lists; size_t arow;
    __device__ __forceinline__ bool next(int i, Unit& u) const {
        const int ntm = tab[32]; const long L = (long)i * G + c; if (L >= ((long)ntm << npn_shift)) return false;
        const int mt = (int)(L >> npn_shift), pn = (int)(L & ((1 << npn_shift) - 1));
        int e = 0;
#pragma unroll
        for (int k = 1; k < 32; ++k) e += (tab[k] <= mt) ? 1 : 0;
        const int lt = mt - tab[e], cnt = tab[64 + e];
        u.pm = 0; u.pn = pn; u.aux = mt * 256; u.flags = 0; u.gl = lists + (size_t)e * LCAP + lt * 256; u.gvalid = (cnt - lt * 256) < 256 ? (cnt - lt * 256) : 256;
        u.A = A + (size_t)mt * arow; u.B = B + (size_t)e * eB + (size_t)pn * tB; u.O = nullptr; return true;
    }
};

constexpr int NPHASE = 11;
__global__ void __launch_bounds__(512, 2) mk_fwd(Args args) {
    extern __shared__ __attribute__((aligned(16))) unsigned char lds_raw[];
    LAS unsigned char* lds = (LAS unsigned char*)lds_raw;
    volatile LAS unsigned* MISC = (volatile LAS unsigned*)(lds + LDSCTL_OFF);
    volatile LAS int* TAB = (volatile LAS int*)(lds + LDSCTL_OFF + 256);
    const int tid = threadIdx.x, lane = tid & 63, wave = __builtin_amdgcn_readfirstlane(tid >> 6);
    const int G = gridDim.x, bx = blockIdx.x;
    const int vcu = (G % 8 == 0) ? (bx % 8) * (G / 8) + bx / 8 : bx;
    unsigned char* ws = args.ws;
    unsigned* ctl = (unsigned*)(ws + WS_CTL);
    float* RS1 = (float*)(ws + WS_RS1); float* RS2 = (float*)(ws + WS_RS2); float* WPAIR = (float*)(ws + WS_WPAIR); float* A32 = (float*)(ws + WS_A32); float* WRF = (float*)(ws + WS_WRF);
    bf16_t* MEMN = (bf16_t*)(ws + WS_MEMN);
    bf16_t *W1T = (bf16_t*)(ws + WS_W1T), *WKVT = (bf16_t*)(ws + WS_WKVT), *WCT = (bf16_t*)(ws + WS_WCT), *WMOT = (bf16_t*)(ws + WS_WMOT), *WGLUT = (bf16_t*)(ws + WS_WGLUT), *WOUTT = (bf16_t*)(ws + WS_WOUTT);
    bf16_t *TOEP = (bf16_t*)(ws + WS_TOEP), *EMAT = (bf16_t*)(ws + WS_EMAT);
    bf16_t *XB = (bf16_t*)(ws + WS_A), *COEF = (bf16_t*)(ws + WS_A), *X1B = (bf16_t*)(ws + WS_A);
    bf16_t *GATES = (bf16_t*)(ws + WS_B), *YS = (bf16_t*)(ws + WS_YS), *WGU = (bf16_t*)(ws + WS_WGU), *WDT = (bf16_t*)(ws + WS_WDT);
    bf16_t *VV = (bf16_t*)(ws + WS_C1), *YG = (bf16_t*)(ws + WS_C1), *QQ = (bf16_t*)(ws + WS_C2), *UG = (bf16_t*)(ws + WS_C3), *MERGED = (bf16_t*)(ws + WS_MERGED);
    bf16_t *VC = (bf16_t*)(ws + WS_C4), *OO = (bf16_t*)(ws + WS_C5), *ABUF = (bf16_t*)(ws + WS_ABUF);
    float* SLOC = (float*)(ws + WS_C6); int* LISTS = (int*)(ws + WS_LIST);
    float* KP = (float*)(ws + WS_C7); float* VP = KP + (size_t)2 * 2048 * 512;
    float* OUT = args.out;

    for (int u = tid; u < (LDS_BYTES - LDSCTL_OFF) / 4; u += 512) ((LAS unsigned*)(lds + LDSCTL_OFF))[u] = 0u;
    __syncthreads();
    XcdBarrier bar; bar.bar = ctl + CW_BAR; bar.x = 0; bar.st = nullptr;
    if (MK_N_LAUNCHES == 1) bar = xcd_barrier_post(ctl + CW_BAR, MISC + 8);
    const int lo = args.ph_lo, hi = args.ph_hi;
#define IN(k) (lo <= (k) && (k) < hi)
#define SEAM(k) do { if (IN(k) && IN((k) + 1)) xcd_barrier(bar); } while (0)
    const int gw = vcu * 8 + wave, NGW = G * 8;

    if (IN(0)) {
        LAS float* scr = (LAS float*)(lds + wave * 16384);
        constexpr int I_W1 = 16 * 160, I_KV = 16 * 32, I_CT = 8 * 32, I_MO = 8 * 32, I_GL = 8 * 64, I_OU = 16 * 32;
        constexpr int I_TR = I_W1 + I_KV + I_CT + I_MO + I_GL + I_OU;
        constexpr int I_T1 = NG * LCH, I_T2 = NG * LCH, I_WR = 48;
        constexpr int NITEMS = I_TR + I_T1 + I_T2 + I_WR + NT + BATCH * MEML;
        for (int it = gw; it < NITEMS; it += NGW) {
            int r = it;
            if (r < I_TR) {
                if (r < I_W1) { const int kb = r / 160, nb = r % 160, n0 = nb * 32; const float cs = (n0 >= 1536 && n0 < 2048) ? 0.08838834764831845f * 1.4426950408889634f : 1.f;
                    tr_item(args.in[I_WIN], INC, w1_colmap(n0), args.in[I_GMIX], cs, W1T, DM, n0, kb * 64, scr, lane); continue; } r -= I_W1;
                if (r < I_KV) { const int kb = r / 32, nb = r % 32; tr_item(args.in[I_WKV], 1024, nb * 32, args.in[I_GMEM], 1.f, WKVT, DM, nb * 32, kb * 64, scr, lane); continue; } r -= I_KV;
                if (r < I_CT) { const int kb = r / 32, nb = r % 32; tr_item(args.in[I_WCONVOUT], 1024, nb * 32, nullptr, DBG_CONV ? 1.f : 0.f, WCT, 512, nb * 32, kb * 64, scr, lane); continue; } r -= I_CT;
                if (r < I_MO) { const int kb = r / 32, nb = r % 32; tr_item(args.in[I_WMO], 1024, nb * 32, nullptr, DBG_MEM ? 1.f : 0.f, WMOT, 512, nb * 32, kb * 64, scr, lane); continue; } r -= I_MO;
                if (r < I_GL) { const int kb = r / 64, nb = r % 64; tr_item(args.in[I_WGLU], 2048, nb * 32, nullptr, (DBG_SSM || nb >= 32) ? 1.f : 0.f, WGLUT, 512, nb * 32, kb * 64, scr, lane); continue; } r -= I_GL;
                { const int kb = r / 32, nb = r % 32; tr_item(args.in[I_WOUT], 1024, nb * 32, nullptr, 1.f, WOUTT, DM, nb * 32, kb * 64, scr, lane); continue; }
            }
            r -= I_TR;
            if (r < I_T1 + I_T2) {
                const bool t1 = r < I_T1; if (!t1) r -= I_T1;
                const int g = r >> 5, jj = r & 31;
                const float dt = expf(args.in[I_LOGDT][g]);
                const float lr = args.in[I_LAMRE][g * NP + lane], li = args.in[I_LAMIM][g * NP + lane];
                float a1r, a1i; cpow_(lr, li, dt, 1, a1r, a1i);
                const float nr = a1r - 1.f, ni = a1i, den = 1.0f / (lr * lr + li * li);
                const float cfr = (nr * lr + ni * li) * den, cfi = (ni * lr - nr * li) * den;
                bf16_t* Tg = TOEP + (size_t)g * 512 * KT; bf16_t* Eg = EMAT + (size_t)g * 256 * 512;
                if (t1) {
                    float pr, pi; cpow_(lr, li, dt, jj, pr, pi);
                    const float wr_ = pr * cfr - pi * cfi, wi_ = pr * cfi + pi * cfr;
                    LAS float* M2r = scr; LAS float* M2i = scr + 1024; LAS float* Cr = scr + 2048; LAS float* Ci = scr + 3072;
#pragma unroll
                    for (int c4 = 0; c4 < 4; ++c4) { const f32x4 br = *(const f32x4*)(args.in[I_BRE] + (size_t)(g * NP + lane) * 16 + c4 * 4), bi = *(const f32x4*)(args.in[I_BIM] + (size_t)(g * NP + lane) * 16 + c4 * 4);
#pragma unroll
                        for (int e = 0; e < 4; ++e) { M2r[lane * 16 + c4 * 4 + e] = wr_ * br[e] - wi_ * bi[e]; M2i[lane * 16 + c4 * 4 + e] = wr_ * bi[e] + wi_ * br[e]; } }
#pragma unroll
                    for (int c = 0; c < 16; ++c) { Cr[c * 64 + lane] = args.in[I_CRE][(size_t)(g * 16 + c) * NP + lane]; Ci[c * 64 + lane] = args.in[I_CIM][(size_t)(g * 16 + c) * NP + lane]; }
                    LDS_WAIT(); asm volatile("" ::: "memory");
                    const int c = lane >> 2, cp0 = (lane & 3) * 4;
                    f32x4 kv = {0.f, 0.f, 0.f, 0.f};
                    for (int p = 0; p < 64; ++p) { const float cr = Cr[c * 64 + p], ci = Ci[c * 64 + p]; const f32x4 mr = *(const LAS f32x4*)(M2r + p * 16 + cp0), mi = *(const LAS f32x4*)(M2i + p * 16 + cp0); kv += mr * cr - mi * ci; }
                    u32x2 w; w.x = pk2(kv[0], kv[1]); w.y = pk2(kv[2], kv[3]); const u32x2 z = {0u, 0u};
                    for (int tau = jj; tau < LCH; ++tau) *(u32x2*)(Tg + (size_t)(tau * 16 + c) * KT + 128 + (tau - jj) * 16 + cp0) = w;
                    if (jj > 0) for (int tp = 0; tp + jj < LCH; ++tp) *(u32x2*)(Tg + (size_t)(tp * 16 + c) * KT + 128 + (tp + jj) * 16 + cp0) = z;
                    LDS_WAIT(); asm volatile("" ::: "memory");
                } else {
                    const int tau = jj;
                    float pr, pi; cpow_(lr, li, dt, tau + 1, pr, pi);
#pragma unroll
                    for (int c = 0; c < 16; ++c) { const float cr = args.in[I_CRE][(size_t)(g * 16 + c) * NP + lane], ci = args.in[I_CIM][(size_t)(g * 16 + c) * NP + lane];
                        Tg[(size_t)(tau * 16 + c) * KT + lane] = (bf16_t)f2bf(cr * pr - ci * pi); Tg[(size_t)(tau * 16 + c) * KT + 64 + lane] = (bf16_t)f2bf(-(cr * pi + ci * pr)); }
                    float qr, qi; cpow_(lr, li, dt, LCH - 1 - tau, qr, qi);
                    const float wr_ = qr * cfr - qi * cfi, wi_ = qr * cfi + qi * cfr;
                    u32x4 er[2], ei[2];
#pragma unroll
                    for (int c8 = 0; c8 < 2; ++c8) { const f32x4 br0 = *(const f32x4*)(args.in[I_BRE] + (size_t)(g * NP + lane) * 16 + c8 * 8), br1 = *(const f32x4*)(args.in[I_BRE] + (size_t)(g * NP + lane) * 16 + c8 * 8 + 4);
                        const f32x4 bi0 = *(const f32x4*)(args.in[I_BIM] + (size_t)(g * NP + lane) * 16 + c8 * 8), bi1 = *(const f32x4*)(args.in[I_BIM] + (size_t)(g * NP + lane) * 16 + c8 * 8 + 4);
                        er[c8] = pack8(br0 * wr_ - bi0 * wi_, br1 * wr_ - bi1 * wi_); ei[c8] = pack8(bi0 * wr_ + br0 * wi_, bi1 * wr_ + br1 * wi_); }
                    *(u32x4*)(Eg + (size_t)lane * 512 + tau * 16) = er[0]; *(u32x4*)(Eg + (size_t)lane * 512 + tau * 16 + 8) = er[1];
                    *(u32x4*)(Eg + (size_t)(64 + lane) * 512 + tau * 16) = ei[0]; *(u32x4*)(Eg + (size_t)(64 + lane) * 512 + tau * 16 + 8) = ei[1];
                    const u32x4 z4 = {0u, 0u, 0u, 0u};
#pragma unroll
                    for (int rr = 0; rr < 4; ++rr) *(u32x4*)(Eg + (size_t)(128 + tau * 4 + rr) * 512 + lane * 8) = z4;
                    if (tau == 0) { float br_, bi_; cpow_(lr, li, dt, LCH, br_, bi_); A32[g * 128 + lane] = br_; A32[g * 128 + 64 + lane] = bi_; }
                }
                continue;
            }
            r -= I_T1 + I_T2;
            if (r < I_WR) {
#pragma unroll
                for (int j = 0; j < 16; ++j) { const int k = j * 64 + lane; float w = 0.f;
                    if (r < 4) w = args.in[I_WRG][(size_t)k * MGR + r]; else if (r < 36) w = args.in[I_WRE][(size_t)k * NE + (r - 4)];
                    WRF[(size_t)r * DM + k] = w * args.in[I_GFFN][k]; }
                continue;
            }
            r -= I_WR;
            if (r < NT) { const float rs = row_to_bf16(args.in[I_X] + (size_t)r * DM, XB + (size_t)r * DM, lane, false); if (lane == 0) RS1[r] = rs; continue; }
            r -= NT;
            (void)row_to_bf16(args.in[I_MEM] + (size_t)r * DM, MEMN + (size_t)r * DM, lane, true);
        }
    }
    SEAM(0);

    if (IN(1)) {
        SchedGrid S; S.ord.init(NT / 256, INC / 256); S.G = G; S.c = bx; S.A = (const char*)XB; S.B = (const char*)W1T; S.tA = (size_t)256 * DM * 2; S.tB = (size_t)256 * DM * 2;
        EpiP1 E{RS1, VV, UG, QQ, GATES};
        pg8::gemm_phase<EpiP1, SchedGrid, false>(lds, DM, DM, DM, S, E);
    }
    SEAM(1);

    if (IN(2)) {
        const int c = bx;
        if (c < 128) {
            const int g = c >> 2, pm = c & 3;
            SchedOne S; S.have = true; S.u0.A = (const char*)(UG + ((size_t)(g * NROW + pm * 256) * KT + 128)); S.u0.B = (const char*)(EMAT + (size_t)g * 256 * 512);
            S.u0.O = (char*)(SLOC + (size_t)g * NROW * 128); S.u0.gl = nullptr; S.u0.pm = pm; S.u0.pn = 0; S.u0.aux = 0; S.u0.flags = 0; S.u0.gvalid = 0;
            EpiF32 E{128, 128};
            pg8::gemm_phase<EpiF32, SchedOne, false>(lds, KT, 512, 512, S, E);
        } else if (c < 192) {
            const int idx = c - 128; SchedOne S; S.have = true; S.u0.gl = nullptr; S.u0.aux = 0; S.u0.flags = 0; S.u0.gvalid = 0;
            int ldc;
            if (idx < 32) { const int pm = idx >> 2, pn = (idx >> 1) & 1, ks = idx & 1;
                S.u0.A = (const char*)(MEMN + (size_t)pm * 256 * DM + ks * 512); S.u0.B = (const char*)(WKVT + (size_t)pn * 256 * DM + ks * 512); S.u0.O = (char*)(KP + (size_t)ks * 2048 * 512); S.u0.pm = pm; S.u0.pn = pn; ldc = 512; }
            else { const int j = idx - 32, pm = j >> 4, pn = (j >> 1) & 7, ks = j & 1;
                S.u0.A = (const char*)(WKVT + (size_t)(512 + pm * 256) * DM + ks * 512); S.u0.B = (const char*)(MEMN + (size_t)pn * 256 * DM + ks * 512); S.u0.O = (char*)(VP + (size_t)ks * 512 * 2048); S.u0.pm = pm; S.u0.pn = pn; ldc = 2048; }
            EpiF32 E{ldc, 1 << 30};
            pg8::gemm_phase<EpiF32, SchedOne, false>(lds, DM, DM, 512, S, E);
        }
        __syncthreads();
        const int ct0 = c < 192 ? c * 2 : 384 + (c - 192) * 10, ctn = c < 192 ? 2 : 10;
        const float* cdw = args.in[I_CONVDW]; const float* cb = args.in[I_CONVB];
        LAS unsigned* vt = (LAS unsigned*)lds;
        LAS float* co = (LAS float*)(lds + 63488);
        const int cp = tid & 255, th = tid >> 8;
        float wk[CKW][2];
#pragma unroll
        for (int k = 0; k < CKW; ++k) { const f32x2 w2 = *(const f32x2*)(cdw + k * CW + 2 * cp); wk[k][0] = w2.x; wk[k][1] = w2.y; }
        const f32x2 bias2 = *(const f32x2*)(cb + 2 * cp);
        f32x4 lng[2], lnb[2];
        lng[0] = *(const f32x4*)(args.in[I_LNG] + lane * 8); lng[1] = *(const f32x4*)(args.in[I_LNG] + lane * 8 + 4);
        lnb[0] = *(const f32x4*)(args.in[I_LNB] + lane * 8); lnb[1] = *(const f32x4*)(args.in[I_LNB] + lane * 8 + 4);
        for (int ct = ct0; ct < ct0 + ctn && ct < 1024; ++ct) {
            const int b = ct >> 7, s0 = (ct & 127) * 32;
            for (int id = tid; id < 62 * 64; id += 512) { const int rr = id >> 6, ch = id & 63; const int s = s0 - 30 + rr;
                u32x4 w = {0u, 0u, 0u, 0u}; if (s >= 0) w = *(const u32x4*)(VV + (size_t)(b * SEQ + s) * CW + ch * 8);
                *(LAS u32x4*)(vt + rr * 256 + ch * 4) = w; }
            __syncthreads();
            float a0[16], a1[16];
#pragma unroll
            for (int j = 0; j < 16; ++j) { a0[j] = bias2.x; a1[j] = bias2.y; }
#pragma unroll
            for (int i = 0; i < 46; ++i) { const unsigned w = vt[(th * 16 + i) * 256 + cp]; const float x0 = bflo(w), x1 = bfhi(w);
#pragma unroll
                for (int j = 0; j < 16; ++j) { const int k = i - j; if (k >= 0 && k < CKW) { a0[j] += wk[k][0] * x0; a1[j] += wk[k][1] * x1; } } }
#pragma unroll
            for (int j = 0; j < 16; ++j) *(LAS f32x2*)(co + (th * 16 + j) * 512 + 2 * cp) = (f32x2){a0[j], a1[j]};
            __syncthreads();
#pragma unroll
            for (int tt = 0; tt < 4; ++tt) { const int tl = wave * 4 + tt;
                f32x4 x0 = *(const LAS f32x4*)(co + tl * 512 + lane * 8), x1 = *(const LAS f32x4*)(co + tl * 512 + lane * 8 + 4);
                const float mean = wave_sum((x0[0] + x0[1]) + (x0[2] + x0[3]) + (x1[0] + x1[1]) + (x1[2] + x1[3])) * (1.f / CW);
                x0 = x0 - mean; x1 = x1 - mean;
                const float var = wave_sum((x0[0] * x0[0] + x0[1] * x0[1]) + (x0[2] * x0[2] + x0[3] * x0[3]) + (x1[0] * x1[0] + x1[1] * x1[1]) + (x1[2] * x1[2] + x1[3] * x1[3])) * (1.f / CW);
                const float rstd = 1.0f / sqrtf(var + EPSN);
                x0 = x0 * rstd * lng[0] + lnb[0]; x1 = x1 * rstd * lng[1] + lnb[1];
                x0 = x0 * sig4(x0); x1 = x1 * sig4(x1);
                *(u32x4*)(VC + (size_t)(b * SEQ + s0 + tl) * CW + lane * 8) = pack8(x0, x1); }
            __syncthreads();
        }
    }
    SEAM(2);

    if (IN(3)) {
        const int c = bx;
        if (wave == 0) {
            const int g = c >> 3, b = c & 7;
            const float ar = A32[g * 128 + lane], ai = A32[g * 128 + 64 + lane];
            float cr = 0.f, ci = 0.f;
            const float* sl = SLOC + (size_t)(g * NROW + b * NCK) * 128; bf16_t* ugp = UG + (size_t)(g * NROW + b * NCK) * KT;
#pragma unroll 8
            for (int k = 0; k < NCK; ++k) {
                const float sr = sl[(size_t)k * 128 + lane], si = sl[(size_t)k * 128 + 64 + lane];
                ugp[(size_t)k * KT + lane] = (bf16_t)f2bf(cr); ugp[(size_t)k * KT + 64 + lane] = (bf16_t)f2bf(ci);
                const float nr = ar * cr - ai * ci + sr, ni = ar * ci + ai * cr + si; cr = nr; ci = ni;
            }
        }
        const int b = c >> 5, h = (c >> 3) & 3;
        LAS unsigned char* Kl = lds; LAS unsigned char* Vl = lds + 69632; LAS float* wsf = (LAS float*)(lds + 136192) + wave * 32;
#pragma unroll
        for (int it = 0; it < 8; ++it) { const int id = it * 512 + tid, key = id >> 4, ch = id & 15;
            const float* p0 = KP + (size_t)(b * MEML + key) * 512 + h * HD + ch * 8; const float* p1 = p0 + (size_t)2048 * 512;
            const f32x4 x0 = *(const f32x4*)p0 + *(const f32x4*)p1, x1 = *(const f32x4*)(p0 + 4) + *(const f32x4*)(p1 + 4);
            *(LAS u32x4*)(Kl + key * 272 + ch * 16) = pack8(x0, x1); }
#pragma unroll
        for (int it = 0; it < 8; ++it) { const int id = it * 512 + tid, d = id >> 5, ch = id & 31;
            const float* p0 = VP + (size_t)(h * HD + d) * 2048 + b * MEML + ch * 8; const float* p1 = p0 + (size_t)512 * 2048;
            const f32x4 x0 = *(const f32x4*)p0 + *(const f32x4*)p1, x1 = *(const f32x4*)(p0 + 4) + *(const f32x4*)(p1 + 4);
            const u32x4 w = pack8(x0, x1); *(LAS u32x2*)(Vl + d * 520 + ch * 16) = (u32x2){w.x, w.y}; *(LAS u32x2*)(Vl + d * 520 + ch * 16 + 8) = (u32x2){w.z, w.w}; }
        __syncthreads();
        const int r32 = lane & 31, hi = lane >> 5;
        for (int uu = 0; uu < 2; ++uu) {
            const int qb = 2 * (c & 7) + uu; const size_t t0 = (size_t)b * SEQ + qb * 256 + wave * 32;
            bf16x8 qf[8];
#pragma unroll
            for (int ks = 0; ks < 8; ++ks) qf[ks] = *(const bf16x8*)(QQ + (t0 + r32) * XW + h * HD + ks * 16 + hi * 8);
            f32x16 sc[8];
#pragma unroll
            for (int kt = 0; kt < 8; ++kt) {
                f32x16 a = {0.f, 0.f, 0.f, 0.f, 0.f, 0.f, 0.f, 0.f, 0.f, 0.f, 0.f, 0.f, 0.f, 0.f, 0.f, 0.f};
#pragma unroll
                for (int ks = 0; ks < 8; ++ks) { const bf16x8 kf = *(const LAS bf16x8*)(Kl + (kt * 32 + r32) * 272 + ks * 32 + hi * 16); a = __builtin_amdgcn_mfma_f32_32x32x16_bf16(kf, qf[ks], a, 0, 0, 0); }
                sc[kt] = a;
            }
            float mx = -3.0e38f;
#pragma unroll
            for (int kt = 0; kt < 8; ++kt)
#pragma unroll
                for (int r = 0; r < 16; ++r) mx = fmaxf(mx, sc[kt][r]);
            mx = fmaxf(mx, __shfl_xor(mx, 32));
            float l = 0.f;
#pragma unroll
            for (int kt = 0; kt < 8; ++kt)
#pragma unroll
                for (int r = 0; r < 16; ++r) { const float p = __builtin_amdgcn_exp2f(sc[kt][r] - mx); sc[kt][r] = p; l += p; }
            l += __shfl_xor(l, 32);
            f32x16 o[4];
#pragma unroll
            for (int dt = 0; dt < 4; ++dt) o[dt] = (f32x16){0.f, 0.f, 0.f, 0.f, 0.f, 0.f, 0.f, 0.f, 0.f, 0.f, 0.f, 0.f, 0.f, 0.f, 0.f, 0.f};
#pragma unroll
            for (int kt = 0; kt < 8; ++kt)
#pragma unroll
                for (int ss = 0; ss < 2; ++ss) {
                    u32x4 pw; pw.x = pk2(sc[kt][8 * ss + 0], sc[kt][8 * ss + 1]); pw.y = pk2(sc[kt][8 * ss + 2], sc[kt][8 * ss + 3]); pw.z = pk2(sc[kt][8 * ss + 4], sc[kt][8 * ss + 5]); pw.w = pk2(sc[kt][8 * ss + 6], sc[kt][8 * ss + 7]);
                    const bf16x8 pa = __builtin_bit_cast(bf16x8, pw);
#pragma unroll
                    for (int dt = 0; dt < 4; ++dt) { const LAS unsigned char* vp = Vl + (dt * 32 + r32) * 520 + (kt * 32 + ss * 16 + 4 * hi) * 2;
                        const u32x2 v0 = *(const LAS u32x2*)vp, v1 = *(const LAS u32x2*)(vp + 16); const u32x4 vw = {v0.x, v0.y, v1.x, v1.y};
                        o[dt] = __builtin_amdgcn_mfma_f32_32x32x16_bf16(pa, __builtin_bit_cast(bf16x8, vw), o[dt], 0, 0, 0); }
                }
            if (hi == 0) wsf[r32] = __builtin_amdgcn_rcpf(l);
            LDS_WAIT(); asm volatile("" ::: "memory");
#pragma unroll
            for (int r = 0; r < 16; ++r) { const int qr = (r & 3) + 8 * (r >> 2) + 4 * hi; const float rl = wsf[qr];
#pragma unroll
                for (int dt = 0; dt < 4; ++dt) OO[(t0 + qr) * XW + h * HD + dt * 32 + r32] = (bf16_t)f2bf(o[dt][r] * rl); }
            LDS_WAIT(); asm volatile("" ::: "memory");
        }
    }
    SEAM(3);

    if (IN(4)) {
        const int c = bx, g = c >> 3, pm = (c >> 1) & 3, pn = c & 1;
        SchedOne S; S.have = true; S.u0.A = (const char*)(UG + (size_t)(g * NROW + pm * 256) * KT); S.u0.B = (const char*)(TOEP + (size_t)(g * 512 + pn * 256) * KT);
        S.u0.O = nullptr; S.u0.gl = nullptr; S.u0.pm = pm; S.u0.pn = pn; S.u0.aux = g; S.u0.flags = 0; S.u0.gvalid = 0;
        EpiP4 E{UG, args.in[I_SSMD], YG};
        pg8::gemm_phase<EpiP4, SchedOne, false>(lds, KT, KT, KT, S, E);
    }
    SEAM(4);

    if (IN(5)) {
        SchedP5 S; S.ord.init(NT / 256, DM / 256); S.G = G; S.c = bx; S.ws = (const char*)ws;
        EpiP5 E{GATES, COEF, MERGED};
        pg8::gemm_phase<EpiP5, SchedP5, false>(lds, 512, 512, 512, S, E);
    }
    SEAM(5);

    if (IN(6)) {
        SchedGrid S; S.ord.init(NT / 256, DM / 256); S.G = G; S.c = bx; S.A = (const char*)MERGED; S.B = (const char*)WOUTT; S.tA = (size_t)256 * DM * 2; S.tB = (size_t)256 * DM * 2;
        EpiP6 E{args.in[I_X], OUT, X1B};
        pg8::gemm_phase<EpiP6, SchedGrid, false>(lds, DM, DM, DM, S, E);
    }
    SEAM(6);

    if (IN(7)) {
        LAS int* lcnt = (LAS int*)(lds + LDSCTL_OFF + 1024); LAS int* lbase = lcnt + 32;
        LAS float* lg = (LAS float*)lds + wave * (16 * 49);
        for (int pass = bx; pass < NT / 128; pass += G) {
            if (tid < 32) lcnt[tid] = 0;
            __syncthreads();
            const int tb = pass * 128 + wave * 16, row = lane & 15, kq = lane >> 4;
            f32x4 ac[3] = {{0.f, 0.f, 0.f, 0.f}, {0.f, 0.f, 0.f, 0.f}, {0.f, 0.f, 0.f, 0.f}}; float ssq = 0.f;
            const float* xr = OUT + (size_t)(tb + row) * DM + 4 * kq; const float* wrp = WRF + (size_t)row * DM + 4 * kq;
#pragma unroll 4
            for (int j = 0; j < 64; ++j) {
                const f32x4 a = *(const f32x4*)(xr + 16 * j);
                ssq += (a[0] * a[0] + a[1] * a[1]) + (a[2] * a[2] + a[3] * a[3]);
#pragma unroll
                for (int nt = 0; nt < 3; ++nt) { const f32x4 bw = *(const f32x4*)(wrp + (size_t)nt * 16 * DM + 16 * j);
#pragma unroll
                    for (int i = 0; i < 4; ++i) ac[nt] = __builtin_amdgcn_mfma_f32_16x16x4f32(a[i], bw[i], ac[nt], 0, 0, 0); }
            }
            ssq += __shfl_xor(ssq, 16); ssq += __shfl_xor(ssq, 32);
#pragma unroll
            for (int nt = 0; nt < 3; ++nt)
#pragma unroll
                for (int r = 0; r < 4; ++r) lg[(kq * 4 + r) * 49 + nt * 16 + row] = ac[nt][r];
            LDS_WAIT(); asm volatile("" ::: "memory");
            int e0 = 0, e1 = 0, rk0 = 0, rk1 = 0; const int tok = tb + lane;
            if (lane < 16) {
                const float rs = 1.0f / sqrtf(ssq * (1.f / DM) + EPSN);
                float gl_[4]; int gi = 0; float gm = -3.0e38f;
#pragma unroll
                for (int k = 0; k < 4; ++k) { gl_[k] = lg[lane * 49 + k] * rs + args.in[I_BRG][k]; if (gl_[k] > gm) { gm = gl_[k]; gi = k; } }
                float gs = 0.f;
#pragma unroll
                for (int k = 0; k < 4; ++k) gs += expf(gl_[k] - gm);
                const float ptop = 1.0f / gs;
                float el[8]; float m1 = -3.0e38f, m2 = -3.0e38f; int i1 = 0, i2 = 0;
#pragma unroll
                for (int k = 0; k < 8; ++k) { el[k] = lg[lane * 49 + 4 + gi * 8 + k] * rs + args.in[I_BRE_E][gi * 8 + k]; }
#pragma unroll
                for (int k = 0; k < 8; ++k) { if (el[k] > m1) { m2 = m1; i2 = i1; m1 = el[k]; i1 = k; } else if (el[k] > m2) { m2 = el[k]; i2 = k; } }
                const float v2 = expf(m2 - m1), inv = 1.0f / (1.0f + v2);
                RS2[tok] = rs; WPAIR[2 * tok] = ptop * inv; WPAIR[2 * tok + 1] = ptop * v2 * inv;
                e0 = gi * 8 + i1; e1 = gi * 8 + i2;
                rk0 = __hip_atomic_fetch_add(lcnt + e0, 1, __ATOMIC_RELAXED, __HIP_MEMORY_SCOPE_WORKGROUP); rk1 = __hip_atomic_fetch_add(lcnt + e1, 1, __ATOMIC_RELAXED, __HIP_MEMORY_SCOPE_WORKGROUP);
            }
            __syncthreads();
            if (tid < 32) lbase[tid] = (int)xb_add(ctl + CW_CNT + tid, (unsigned)lcnt[tid]);
            __syncthreads();
            if (lane < 16) { LISTS[(size_t)e0 * LCAP + lbase[e0] + rk0] = 2 * tok; LISTS[(size_t)e1 * LCAP + lbase[e1] + rk1] = 2 * tok + 1; }
            __syncthreads();
        }
        LAS float* scr = (LAS float*)(lds + wave * 16384);
        constexpr int I_GU = 16 * 16, I_DN = 4 * 32;
        for (int it = gw; it < NE * (I_GU + I_DN); it += NGW) {
            const int e = it / (I_GU + I_DN); int r = it % (I_GU + I_DN);
            if (r < I_GU) { const int kb = r / 16, nb = r % 16, n0 = nb * 32, pn = n0 >> 8, j = n0 & 255;
                const float* src = (j < 128 ? args.in[I_WEG] : args.in[I_WEU]) + (size_t)e * DM * DE; const int c0 = 128 * pn + (j & 127);
                tr_item(src, DE, c0, args.in[I_GFFN], 1.f, WGU + (size_t)e * 512 * DM, DM, n0, kb * 64, scr, lane); }
            else { r -= I_GU; const int kb = r / 32, nb = r % 32; tr_item(args.in[I_WED] + (size_t)e * DE * DM, DM, nb * 32, nullptr, 1.f, WDT + (size_t)e * DM * DE, DE, nb * 32, kb * 64, scr, lane); }
        }
    }
    SEAM(7);

    if (IN(8) || IN(9)) {
        if (tid == 0) { int acc_ = 0; for (int e = 0; e < NE; ++e) { const int cn = (int)xb_ld(ctl + CW_CNT + e); TAB[e] = acc_; TAB[64 + e] = cn; acc_ += (cn + 255) >> 8; } TAB[32] = acc_; }
        __syncthreads();
    }
    if (IN(8)) {
        SchedMoe S; S.tab = TAB; S.G = G; S.c = bx; S.npn_shift = 1; S.A = (const char*)X1B; S.B = (const char*)WGU; S.eB = (size_t)512 * DM * 2; S.tB = (size_t)256 * DM * 2; S.lists = LISTS; S.arow = 0;
        EpiP8 E{RS2, ABUF};
        pg8::gemm_phase<EpiP8, SchedMoe, true>(lds, DM, DM, DM, S, E);
    }
    SEAM(8);
    if (IN(9)) {
        SchedMoe S; S.tab = TAB; S.G = G; S.c = bx; S.npn_shift = 2; S.A = (const char*)ABUF; S.B = (const char*)WDT; S.eB = (size_t)DM * DE * 2; S.tB = (size_t)256 * DE * 2; S.lists = LISTS; S.arow = (size_t)256 * DE * 2;
        EpiP9 E{WPAIR, YS, VV};
        pg8::gemm_phase<EpiP9, SchedMoe, false>(lds, DE, DE, DE, S, E);
    }
    SEAM(9);

    if (IN(10)) {
        f32x4 gf[4];
#pragma unroll
        for (int j = 0; j < 4; ++j) gf[j] = *((const f32x4*)args.in[I_GFINAL] + lane + 64 * j);
        for (int m = gw; m < NT; m += NGW) {
            f32x4* xr = (f32x4*)(OUT + (size_t)m * DM) + lane;
            const u32x2* y0 = (const u32x2*)(YS + (size_t)(2 * m) * DM) + lane; const u32x2* y1 = (const u32x2*)(YS + (size_t)(2 * m + 1) * DM) + lane;
            f32x4 v[4]; float s = 0.f;
#pragma unroll
            for (int j = 0; j < 4; ++j) { v[j] = xr[64 * j];
                if (DBG_MOE) { const u32x2 a = y0[64 * j], b = y1[64 * j]; v[j] += (f32x4){bflo(a.x) + bflo(b.x), bfhi(a.x) + bfhi(b.x), bflo(a.y) + bflo(b.y), bfhi(a.y) + bfhi(b.y)}; }
                s += (v[j].x * v[j].x + v[j].y * v[j].y) + (v[j].z * v[j].z + v[j].w * v[j].w); }
            const float rs = 1.0f / sqrtf(wave_sum(s) * (1.f / DM) + EPSN);
#pragma unroll
            for (int j = 0; j < 4; ++j) xr[64 * j] = v[j] * rs * gf[j];
        }
    }
#undef IN
#undef SEAM
}

extern "C" void kernel_launch(void* const* d_in, const int* in_sizes, int n_in, void* d_out, int out_size, void* d_ws, size_t ws_size, hipStream_t stream) {
    static int grid = 0;
    if (grid == 0) {
        if (n_in != 31 || in_sizes[0] != NT * DM || out_size != NT * DM || ws_size < WS_END) { fprintf(stderr, "kernel_launch: unexpected shapes/workspace (n_in %d, ws %zu)\n", n_in, ws_size); grid = -1; return; }
        int dev = 0, cus = 0, per_cu = 0;
        if (hipGetDevice(&dev) != hipSuccess || hipDeviceGetAttribute(&cus, hipDeviceAttributeMultiprocessorCount, dev) != hipSuccess) { grid = -1; return; }
        if (hipFuncSetAttribute((const void*)mk_fwd, hipFuncAttributeMaxDynamicSharedMemorySize, LDS_BYTES) != hipSuccess) { fprintf(stderr, "kernel_launch: hipFuncSetAttribute failed\n"); grid = -1; return; }
        if (hipOccupancyMaxActiveBlocksPerMultiprocessor(&per_cu, (const void*)mk_fwd, 512, LDS_BYTES) != hipSuccess || per_cu < 1) fprintf(stderr, "kernel_launch: occupancy query says %d\n", per_cu);
        (void)hipGetLastError();
        grid = cus;
        if (grid != 256) fprintf(stderr, "kernel_launch: %d CUs (built for 256)\n", grid);
    }
    if (grid < 0) return;
    if (hipMemsetAsync((char*)d_ws + WS_CTL, 0, CTL_ZERO_BYTES, stream) != hipSuccess) return;
    Args a{};
    for (int i = 0; i < 31; ++i) a.in[i] = (const float*)d_in[i];
    a.out = (float*)d_out; a.ws = (unsigned char*)d_ws;
    const int nl = (MK_N_LAUNCHES == 1) ? 1 : NPHASE;
    for (int li = 0; li < nl; ++li) {
        a.ph_lo = (nl == 1) ? 0 : li; a.ph_hi = (nl == 1) ? NPHASE : li + 1; a.li = li;
        hipLaunchKernelGGL(mk_fwd, dim3(grid), dim3(512), LDS_BYTES, stream, a);
    }
}
```
